# Optimizing an MI355X kernel written in HIP

```python
import math
import jax, jax.numpy as jnp
from jax import lax
import numpy as np

D_MODEL = 1024
BATCH = 2
SEQ = 8192
DEPTH = 1

D_MIX = D_MODEL
D_ATTN = D_MIX // 2
D_RNN = D_MIX - D_ATTN
HEAD_DIM = 64
N_HEADS = D_ATTN // HEAD_DIM
N_KV_HEADS = 2
GQA_REP = N_HEADS // N_KV_HEADS
D_KV = N_KV_HEADS * HEAD_DIM
CMP_LEN = 32
CMP_STRIDE = 16
SEL_BLOCK = 64
N_SEL = 16
WINDOW = 512
Q_BLOCK = 128
FORCE_BONUS = 1e4
N_BUCKETS = 32
MAX_DISTANCE = 128
RG_BLOCKS = 8
RG_BLOCK_DIM = D_RNN // RG_BLOCKS
CONV_WIDTH = 4
RG_C = 8.0
N_GROUPS = 4
EXPERTS_PER_GROUP = 4
N_EXPERTS = N_GROUPS * EXPERTS_PER_GROUP
TOP_K_INNER = 2
D_FF_EXPERT = 512
D_PLE = 256
ALPHA = (2.0 * DEPTH) ** 0.25
BETA = (8.0 * DEPTH) ** -0.25
LN_EPS = 1e-5
RMS_EPS = 1e-6
NEG = -1e30
N_GATE_COLS = 3 * N_HEADS
SPLIT_IDX = [D_ATTN, D_ATTN + 6 * D_KV, D_ATTN + 6 * D_KV + N_GATE_COLS,
             D_ATTN + 6 * D_KV + N_GATE_COLS + D_RNN]
D_IN_PROJ = D_ATTN + 6 * D_KV + N_GATE_COLS + 2 * D_RNN

kernel_name = 'hymba_nsa_rglru_hmoe_deepnorm'


def layer_norm(x, g, b):
    xf = x.astype(jnp.float32)
    mu = jnp.mean(xf, axis=-1, keepdims=True)
    var = jnp.mean(jnp.square(xf - mu), axis=-1, keepdims=True)
    y = (xf - mu) * lax.rsqrt(var + LN_EPS) * g.astype(jnp.float32) + b.astype(jnp.float32)
    return y.astype(x.dtype)


def rms_norm(x, g):
    xf = x.astype(jnp.float32)
    y = xf * lax.rsqrt(jnp.mean(jnp.square(xf), axis=-1, keepdims=True) + RMS_EPS)
    return y * g.astype(jnp.float32)


def t5_bucket(dist):
    max_exact = N_BUCKETS // 2
    d = jnp.maximum(dist, 0)
    df = jnp.maximum(d, 1).astype(jnp.float32)
    large = max_exact + (jnp.log(df / max_exact) / math.log(MAX_DISTANCE / max_exact)
                         * (N_BUCKETS - max_exact)).astype(jnp.int32)
    large = jnp.minimum(large, N_BUCKETS - 1)
    return jnp.where(d < max_exact, d, large)


def masked_softmax(logits, mask):
    lf = jnp.where(mask, logits.astype(jnp.float32), NEG)
    m = jnp.max(lf, axis=-1, keepdims=True)
    e = jnp.where(mask, jnp.exp(lf - m), 0.0)
    return e / jnp.maximum(jnp.sum(e, axis=-1, keepdims=True), 1e-30)


def nsa_attention(q, k_cmp_raw, v_cmp_raw, k_slc, v_slc, k_win, v_win, gates,
                  cmp_pe_k, cmp_pe_v, cmp_w_k, cmp_w_v, rel_bias):
    B, T = q.shape[0], q.shape[1]
    G, R, Dh = N_KV_HEADS, GQA_REP, HEAD_DIM
    n_cmp = (T - CMP_LEN) // CMP_STRIDE + 1
    n_slc = T // SEL_BLOCK
    n_sel = min(N_SEL, n_slc)
    n_qblk = T // Q_BLOCK
    scale = Dh ** -0.5

    tok = jnp.arange(n_cmp)[:, None] * CMP_STRIDE + jnp.arange(CMP_LEN)[None, :]

    def compress(raw, pe, w):
        blk = raw[:, tok] + pe[None, None, :, None, :]
        blk = jnp.moveaxis(blk, 3, 2).reshape(B, n_cmp, G, CMP_LEN * Dh)
        return blk @ w

    k_c = compress(k_cmp_raw, cmp_pe_k, cmp_w_k)
    v_c = compress(v_cmp_raw, cmp_pe_v, cmp_w_v)
    cmp_end = jnp.arange(n_cmp) * CMP_STRIDE + CMP_LEN - 1
    cs = jnp.arange(n_cmp) * CMP_STRIDE
    ss = jnp.arange(n_slc) * SEL_BLOCK
    overlap = ((cs[:, None] < ss[None, :] + SEL_BLOCK) &
               (cs[:, None] + CMP_LEN > ss[None, :])).astype(jnp.float32)

    k_s_t = jnp.moveaxis(k_slc, 1, 2)
    v_s_t = jnp.moveaxis(v_slc, 1, 2)
    k_w_p = jnp.pad(k_win, ((0, 0), (WINDOW, 0), (0, 0), (0, 0)))
    v_w_p = jnp.pad(v_win, ((0, 0), (WINDOW, 0), (0, 0), (0, 0)))

    tab = rel_bias.T.reshape(G, R, N_BUCKETS)
    g_ix = jnp.arange(G)[None, :, None, None, None]
    r_ix = jnp.arange(R)[None, None, :, None, None]
    sblk = jnp.arange(n_slc)

    def block(i):
        qs = i * Q_BLOCK
        qpos = qs + jnp.arange(Q_BLOCK)
        qb = lax.dynamic_slice_in_dim(q, qs, Q_BLOCK, axis=1).reshape(B, Q_BLOCK, G, R, Dh) * scale
        gb = lax.dynamic_slice_in_dim(gates, qs, Q_BLOCK, axis=1)

        dist_c = qpos[:, None] - cmp_end[None, :]
        s_c = jnp.einsum('bqgrd,bcgd->bgrqc', qb, k_c) + tab[:, :, t5_bucket(dist_c)]
        p_c = masked_softmax(s_c, dist_c >= 0)
        o_c = jnp.einsum('bgrqc,bcgd->bqgrd', p_c, v_c)

        imp = jnp.einsum('bgrqc,cs->bgqs', p_c, overlap)
        cur = (qpos // SEL_BLOCK)[:, None]
        valid = sblk[None, :] <= cur
        forced = (sblk[None, :] == 0) | (sblk[None, :] == cur) | (sblk[None, :] == cur - 1)
        score = jnp.where(valid, imp + jnp.where(forced, FORCE_BONUS, 0.0), NEG)
        _, sel = lax.top_k(score, n_sel)

        kidx = (sel[..., None] * SEL_BLOCK + jnp.arange(SEL_BLOCK)).reshape(B, G, Q_BLOCK * n_sel * SEL_BLOCK)
        ks = jnp.take_along_axis(k_s_t, kidx[..., None], axis=2).reshape(B, G, Q_BLOCK, n_sel * SEL_BLOCK, Dh)
        vs = jnp.take_along_axis(v_s_t, kidx[..., None], axis=2).reshape(B, G, Q_BLOCK, n_sel * SEL_BLOCK, Dh)
        kpos = kidx.reshape(B, G, Q_BLOCK, n_sel * SEL_BLOCK)
        dist_s = qpos[None, None, :, None] - kpos
        bias_s = tab[g_ix, r_ix, t5_bucket(dist_s)[:, :, None]]
        s_s = jnp.einsum('bqgrd,bgqkd->bgrqk', qb, ks) + bias_s
        p_s = masked_softmax(s_s, (dist_s >= 0)[:, :, None])
        o_s = jnp.einsum('bgrqk,bgqkd->bqgrd', p_s, vs)

        kw = lax.dynamic_slice_in_dim(k_w_p, qs, WINDOW + Q_BLOCK, axis=1)
        vw = lax.dynamic_slice_in_dim(v_w_p, qs, WINDOW + Q_BLOCK, axis=1)
        wpos = qs - WINDOW + jnp.arange(WINDOW + Q_BLOCK)
        dist_w = qpos[:, None] - wpos[None, :]
        mask_w = (dist_w >= 0) & (dist_w < WINDOW) & (wpos[None, :] >= 0)
        s_w = jnp.einsum('bqgrd,bkgd->bgrqk', qb, kw) + tab[:, :, t5_bucket(dist_w)]
        p_w = masked_softmax(s_w, mask_w)
        o_w = jnp.einsum('bgrqk,bkgd->bqgrd', p_w, vw)

        out = gb[..., 0:1] * o_c + gb[..., 1:2] * o_s + gb[..., 2:3] * o_w
        return out.reshape(B, Q_BLOCK, N_HEADS * Dh)

    out = lax.map(block, jnp.arange(n_qblk))
    return jnp.moveaxis(out, 0, 1).reshape(B, T, N_HEADS * Dh)


def rglru_branch(xr, yr, conv_w, conv_b, w_a, b_a, w_x, b_x, lam):
    B, T, C = xr.shape
    xf = xr.astype(jnp.float32)
    xc = lax.conv_general_dilated(xf, conv_w.astype(jnp.float32).reshape(CONV_WIDTH, 1, C),
                                  window_strides=(1,), padding=[(CONV_WIDTH - 1, 0)],
                                  dimension_numbers=('NWC', 'WIO', 'NWC'),
                                  feature_group_count=C) + conv_b.astype(jnp.float32)
    xb = xc.reshape(B, T, RG_BLOCKS, RG_BLOCK_DIM)
    r = jax.nn.sigmoid(jnp.einsum('btnk,nkj->btnj', xb, w_a.astype(jnp.float32)).reshape(B, T, C) + b_a)
    i_g = jax.nn.sigmoid(jnp.einsum('btnk,nkj->btnj', xb, w_x.astype(jnp.float32)).reshape(B, T, C) + b_x)
    log_a = -RG_C * r * jax.nn.softplus(-lam.astype(jnp.float32))
    a = jnp.exp(log_a)
    bterm = jnp.sqrt(-jnp.expm1(2.0 * log_a)) * (i_g * xc)

    def combine(c1, c2):
        a1, b1 = c1
        a2, b2 = c2
        return a1 * a2, a2 * b1 + b2

    _, h = lax.associative_scan(combine, (a, bterm), axis=1)
    return h * jax.nn.gelu(yr.astype(jnp.float32))


def hmoe(h, wg, bg, we, be, w_up, w_down):
    B, T, D = h.shape
    t = h.reshape(B * T, D)
    n = t.shape[0]
    pg = jax.nn.softmax((t @ wg + bg).astype(jnp.float32), axis=-1)
    pg_top, gi = lax.top_k(pg, 1)
    le = (t @ we + be).astype(jnp.float32).reshape(n, N_GROUPS, EXPERTS_PER_GROUP)
    le_g = jnp.take_along_axis(le, gi[:, :, None], axis=1)[:, 0]
    pe = jax.nn.softmax(le_g, axis=-1)
    pe_top, ei = lax.top_k(pe, TOP_K_INNER)
    w = pg_top * pe_top / jnp.sum(pe_top, axis=-1, keepdims=True)
    eid = gi * EXPERTS_PER_GROUP + ei
    comb = jnp.sum(jax.nn.one_hot(eid, N_EXPERTS, dtype=jnp.float32) * w[..., None], axis=1)
    out = jnp.zeros((n, D), jnp.float32)
    for e in range(N_EXPERTS):
        u = t @ w_up[e]
        ua, ub = jnp.split(u, 2, axis=-1)
        out = out + comb[:, e:e + 1] * ((jax.nn.silu(ua) * ub) @ w_down[e])
    return out.reshape(B, T, D).astype(h.dtype)


def setup_inputs(seed: int = 0) -> dict:
    key = jax.random.key(seed)
    ks = jax.random.split(key, 32)
    f32 = jnp.float32
    nrm = lambda k, shape, s: jax.random.normal(k, shape, f32) * s
    col_scale = jnp.concatenate([
        jnp.ones((D_ATTN,), f32),
        jnp.ones((D_KV,), f32), jnp.full((D_KV,), BETA, f32),
        jnp.ones((D_KV,), f32), jnp.full((D_KV,), BETA, f32),
        jnp.ones((D_KV,), f32), jnp.full((D_KV,), BETA, f32),
        jnp.ones((N_GATE_COLS,), f32),
        jnp.full((D_RNN,), BETA, f32), jnp.ones((D_RNN,), f32)])
    u = jax.random.uniform(ks[10], (DEPTH, D_RNN), f32, 0.9, 0.999)
    a0 = u ** (1.0 / RG_C)
    return {
        'x': nrm(ks[0], (BATCH, SEQ, D_MODEL), 1.0),
        'p': nrm(ks[1], (DEPTH, BATCH, SEQ, D_PLE), 1.0),
        'rel_bias': nrm(ks[2], (N_BUCKETS, N_HEADS), 0.2),
        'w_in': nrm(ks[3], (DEPTH, D_MODEL, D_IN_PROJ), D_MODEL ** -0.5) * col_scale,
        'cmp_pe_k': nrm(ks[4], (DEPTH, CMP_LEN, HEAD_DIM), 0.02),
        'cmp_pe_v': nrm(ks[5], (DEPTH, CMP_LEN, HEAD_DIM), 0.02),
        'cmp_w_k': nrm(ks[6], (DEPTH, CMP_LEN * HEAD_DIM, HEAD_DIM), (CMP_LEN * HEAD_DIM) ** -0.5),
        'cmp_w_v': nrm(ks[7], (DEPTH, CMP_LEN * HEAD_DIM, HEAD_DIM), (CMP_LEN * HEAD_DIM) ** -0.5),
        'conv_w': nrm(ks[8], (DEPTH, CONV_WIDTH, D_RNN), CONV_WIDTH ** -0.5),
        'conv_b': nrm(ks[9], (DEPTH, D_RNN), 0.02),
        'rg_w_a': nrm(ks[11], (DEPTH, RG_BLOCKS, RG_BLOCK_DIM, RG_BLOCK_DIM), RG_BLOCK_DIM ** -0.5),
        'rg_b_a': nrm(ks[12], (DEPTH, D_RNN), 0.02),
        'rg_w_x': nrm(ks[13], (DEPTH, RG_BLOCKS, RG_BLOCK_DIM, RG_BLOCK_DIM), RG_BLOCK_DIM ** -0.5),
        'rg_b_x': nrm(ks[14], (DEPTH, D_RNN), 0.02),
        'rg_lambda': jnp.log(a0 / (1.0 - a0)),
        'attn_out_gain': 1.0 + nrm(ks[15], (DEPTH, D_ATTN), 0.02),
        'rnn_out_gain': 1.0 + nrm(ks[16], (DEPTH, D_RNN), 0.02),
        'w_out': nrm(ks[17], (DEPTH, D_MIX, D_MODEL), D_MIX ** -0.5 * BETA),
        'ln1_g': 1.0 + nrm(ks[18], (DEPTH, D_MODEL), 0.02),
        'ln1_b': nrm(ks[19], (DEPTH, D_MODEL), 0.02),
        'router_group_w': nrm(ks[20], (DEPTH, D_MODEL, N_GROUPS), D_MODEL ** -0.5),
        'router_group_b': nrm(ks[21], (DEPTH, N_GROUPS), 0.01),
        'router_expert_w': nrm(ks[22], (DEPTH, D_MODEL, N_EXPERTS), D_MODEL ** -0.5),
        'router_expert_b': nrm(ks[23], (DEPTH, N_EXPERTS), 0.01),
        'expert_w_up': nrm(ks[24], (DEPTH, N_EXPERTS, D_MODEL, 2 * D_FF_EXPERT), D_MODEL ** -0.5),
        'expert_w_down': nrm(ks[25], (DEPTH, N_EXPERTS, D_FF_EXPERT, D_MODEL), D_FF_EXPERT ** -0.5 * BETA),
        'ple_w': nrm(ks[26], (DEPTH, D_PLE, D_MODEL), D_PLE ** -0.5 * BETA),
        'ple_gate_w': nrm(ks[27], (DEPTH, D_MODEL, D_MODEL), D_MODEL ** -0.5),
        'ln2_g': 1.0 + nrm(ks[28], (DEPTH, D_MODEL), 0.02),
        'ln2_b': nrm(ks[29], (DEPTH, D_MODEL), 0.02),
    }


def reference(x, p, rel_bias, w_in, cmp_pe_k, cmp_pe_v, cmp_w_k, cmp_w_v, conv_w, conv_b,
              rg_w_a, rg_b_a, rg_w_x, rg_b_x, rg_lambda, attn_out_gain, rnn_out_gain, w_out,
              ln1_g, ln1_b, router_group_w, router_group_b, router_expert_w, router_expert_b,
              expert_w_up, expert_w_down, ple_w, ple_gate_w, ln2_g, ln2_b):
    B, T, _ = x.shape
    for i in range(DEPTH):
        proj = x @ w_in[i]
        q, kv, g, rx, ry = jnp.split(proj, SPLIT_IDX, axis=-1)
        q = q.reshape(B, T, N_HEADS, HEAD_DIM)
        k_c, v_c, k_s, v_s, k_w, v_w = [c.reshape(B, T, N_KV_HEADS, HEAD_DIM)
                                        for c in jnp.split(kv, 6, axis=-1)]
        gates = jax.nn.sigmoid(g).reshape(B, T, N_KV_HEADS, GQA_REP, 3)
        attn = nsa_attention(q, k_c, v_c, k_s, v_s, k_w, v_w, gates,
                             cmp_pe_k[i], cmp_pe_v[i], cmp_w_k[i], cmp_w_v[i], rel_bias)
        rnn = rglru_branch(rx, ry, conv_w[i], conv_b[i], rg_w_a[i], rg_b_a[i],
                           rg_w_x[i], rg_b_x[i], rg_lambda[i])
        heads = jnp.concatenate([rms_norm(attn, attn_out_gain[i]),
                                 rms_norm(rnn, rnn_out_gain[i])], axis=-1).astype(x.dtype)
        mix = heads @ w_out[i]
        x = layer_norm(ALPHA * x + mix, ln1_g[i], ln1_b[i])
        moe = hmoe(x, router_group_w[i], router_group_b[i], router_expert_w[i],
                   router_expert_b[i], expert_w_up[i], expert_w_down[i])
        ple = jax.nn.sigmoid(x @ ple_gate_w[i]) * (p[i] @ ple_w[i])
        x = layer_norm(ALPHA * x + moe + ple, ln2_g[i], ln2_b[i])
    return x
```

```cpp
#ifdef CPU_EMU
#include <cmath>
#include <cstddef>
#define HD
#else
#include <hip/hip_runtime.h>
#define HD __host__ __device__
#endif

#ifndef SEQ
#define SEQ 8192
#endif
#ifndef BATCH
#define BATCH 2
#endif

namespace {
constexpr int T_ = SEQ, B_ = BATCH, NTOK = B_ * T_;
constexpr int DM = 1024, DIP = 2328;
constexpr int C_Q = 0, C_KC = 512, C_VC = 640, C_KS = 768, C_VS = 896, C_KW = 1024, C_VW = 1152, C_G = 1280, C_RX = 1304, C_RY = 1816;
constexpr int NCMP = (T_ - 32) / 16 + 1, NSLC = T_ / 64;
constexpr float ALPHA = 1.189207115002721f;
constexpr float NEGF = -1e30f;

struct P {
  const float *x, *p, *rel_bias, *w_in, *pe_k, *pe_v, *cw_k, *cw_v, *conv_w, *conv_b, *w_a, *b_a, *w_x, *b_x, *lam,
      *g_attn, *g_rnn, *w_out, *ln1_g, *ln1_b, *wg, *bg, *we, *be, *w_up, *w_down, *ple_w, *ple_gate, *ln2_g, *ln2_b;
  float *out;
  float *proj, *attn, *ra, *rb, *kc, *vc, *imp, *mc, *lc, *invrms, *ew, *x1, *hid;
  int *sel, *eid;
};

HD inline int t5_bucket(int dist) {
  int d = dist < 0 ? 0 : dist;
  if (d < 16) return d;
  int b = 16;
  b += (d >= 19) + (d >= 21) + (d >= 24) + (d >= 27) + (d >= 31) + (d >= 35) + (d >= 40) + (d >= 46) + (d >= 52) +
       (d >= 59) + (d >= 67) + (d >= 77) + (d >= 87) + (d >= 99) + (d >= 113);
  return b;
}
HD inline float sigmoidf_(float v) { return 1.f / (1.f + expf(-v)); }

HD inline void s_proj(const P& p, long i) {
  int n = (int)(i / DIP), c = (int)(i % DIP);
  const float* xr = p.x + (long)n * DM;
  float acc = 0.f;
  for (int k = 0; k < DM; ++k) acc += xr[k] * p.w_in[(long)k * DIP + c];
  p.proj[i] = acc;
}
HD inline void s_compress(const P& p, long i) {
  int j = (int)(i % 64); long r = i / 64;
  int g = (int)(r % 2); r /= 2;
  int c = (int)(r % NCMP); r /= NCMP;
  int b = (int)(r % B_); int kv = (int)(r / B_);
  const float* pe = kv ? p.pe_v : p.pe_k;
  const float* w = kv ? p.cw_v : p.cw_k;
  int col = (kv ? C_VC : C_KC) + g * 64;
  float acc = 0.f;
  for (int l = 0; l < 32; ++l) {
    const float* row = p.proj + ((long)b * T_ + c * 16 + l) * DIP + col;
    for (int d = 0; d < 64; ++d) acc += (row[d] + pe[l * 64 + d]) * w[(l * 64 + d) * 64 + j];
  }
  (kv ? p.vc : p.kc)[(((long)b * NCMP + c) * 2 + g) * 64 + j] = acc;
}
HD inline void s_cmp_attn(const P& p, long i) {
  int h = (int)(i % 8); long n = i / 8; int q = (int)(n % T_); int b = (int)(n / T_);
  int g = h / 4;
  const float* qr = p.proj + n * DIP + C_Q + h * 64;
  float qv[64];
#pragma unroll
  for (int d = 0; d < 64; ++d) qv[d] = qr[d] * 0.125f;
  int nvalid = (q >= 31) ? ((q - 31) / 16 + 1) : 0;
  if (nvalid > NCMP) nvalid = NCMP;
  float m = NEGF;
  for (int c = 0; c < nvalid; ++c) {
    const float* kr = p.kc + (((long)b * NCMP + c) * 2 + g) * 64;
    float s = 0.f;
#pragma unroll
    for (int d = 0; d < 64; ++d) s += qv[d] * kr[d];
    s += p.rel_bias[t5_bucket(q - (c * 16 + 31)) * 8 + h];
    m = s > m ? s : m;
  }
  float o[64];
#pragma unroll
  for (int d = 0; d < 64; ++d) o[d] = 0.f;
  float l = 0.f;
  for (int c = 0; c < nvalid; ++c) {
    const float* kr = p.kc + (((long)b * NCMP + c) * 2 + g) * 64;
    const float* vr = p.vc + (((long)b * NCMP + c) * 2 + g) * 64;
    float s = 0.f;
#pragma unroll
    for (int d = 0; d < 64; ++d) s += qv[d] * kr[d];
    s += p.rel_bias[t5_bucket(q - (c * 16 + 31)) * 8 + h];
    float e = expf(s - m);
    l += e;
#pragma unroll
    for (int d = 0; d < 64; ++d) o[d] += e * vr[d];
  }
  float gate = sigmoidf_(p.proj[n * DIP + C_G + h * 3 + 0]);
  float inv = gate / fmaxf(l, 1e-30f);
  float* ar = p.attn + n * 512 + h * 64;
#pragma unroll
  for (int d = 0; d < 64; ++d) ar[d] = o[d] * inv;
  p.mc[i] = m; p.lc[i] = l;
}
HD inline void s_imp(const P& p, long i) {
  int s = (int)(i % NSLC); long r = i / NSLC; int q = (int)(r % T_); r /= T_; int g = (int)(r % 2); int b = (int)(r / 2);
  long n = (long)b * T_ + q;
  int c0 = 4 * s - 1; if (c0 < 0) c0 = 0;
  int c1 = 4 * s + 3; if (c1 > NCMP - 1) c1 = NCMP - 1;
  float acc = 0.f;
  for (int rr = 0; rr < 4; ++rr) {
    int h = g * 4 + rr;
    const float* qr = p.proj + n * DIP + C_Q + h * 64;
    float m = p.mc[n * 8 + h], l = fmaxf(p.lc[n * 8 + h], 1e-30f);
    for (int c = c0; c <= c1; ++c) {
      if (c * 16 + 31 > q) continue;
      const float* kr = p.kc + (((long)b * NCMP + c) * 2 + g) * 64;
      float sc = 0.f;
      for (int d = 0; d < 64; ++d) sc += (qr[d] * 0.125f) * kr[d];
      sc += p.rel_bias[t5_bucket(q - (c * 16 + 31)) * 8 + h];
      acc += expf(sc - m) / l;
    }
  }
  p.imp[i] = acc;
}
HD inline void s_topk(const P& p, long i) {
  int q = (int)(i % T_);
  int cur = q / 64;
  const float* im = p.imp + i * NSLC;
  unsigned m0 = 0, m1 = 0, m2 = 0, m3 = 0;
  int nsel = NSLC < 16 ? NSLC : 16;
  for (int k = 0; k < nsel; ++k) {
    float best = -3e38f; int bi = 0;
    for (int s = 0; s < NSLC; ++s) {
      unsigned w = s < 32 ? m0 : (s < 64 ? m1 : (s < 96 ? m2 : m3));
      if ((w >> (s & 31)) & 1u) continue;
      float sc;
      if (s <= cur) { bool forced = (s == 0) || (s == cur) || (s == cur - 1); sc = im[s] + (forced ? 1e4f : 0.f); }
      else sc = NEGF;
      if (sc > best) { best = sc; bi = s; }
    }
    unsigned bit = 1u << (bi & 31);
    if (bi < 32) m0 |= bit; else if (bi < 64) m1 |= bit; else if (bi < 96) m2 |= bit; else m3 |= bit;
    p.sel[i * 16 + k] = bi;
  }
}
HD inline void s_sel_attn(const P& p, long i) {
  int h = (int)(i % 8); long n = i / 8; int q = (int)(n % T_); int b = (int)(n / T_);
  int g = h / 4;
  const float* qr = p.proj + n * DIP + C_Q + h * 64;
  float qv[64];
#pragma unroll
  for (int d = 0; d < 64; ++d) qv[d] = qr[d] * 0.125f;
  const int* sl = p.sel + (((long)b * 2 + g) * T_ + q) * 16;
  int nsel = NSLC < 16 ? NSLC : 16;
  float m = NEGF;
  for (int k = 0; k < nsel; ++k) {
    int blk = sl[k];
    for (int t = 0; t < 64; ++t) {
      int kp = blk * 64 + t;
      if (kp > q) break;
      const float* kr = p.proj + ((long)b * T_ + kp) * DIP + C_KS + g * 64;
      float s = 0.f;
#pragma unroll
      for (int d = 0; d < 64; ++d) s += qv[d] * kr[d];
      s += p.rel_bias[t5_bucket(q - kp) * 8 + h];
      m = s > m ? s : m;
    }
  }
  float o[64];
#pragma unroll
  for (int d = 0; d < 64; ++d) o[d] = 0.f;
  float l = 0.f;
  for (int k = 0; k < nsel; ++k) {
    int blk = sl[k];
    for (int t = 0; t < 64; ++t) {
      int kp = blk * 64 + t;
      if (kp > q) break;
      const float* kr = p.proj + ((long)b * T_ + kp) * DIP + C_KS + g * 64;
      const float* vr = p.proj + ((long)b * T_ + kp) * DIP + C_VS + g * 64;
      float s = 0.f;
#pragma unroll
      for (int d = 0; d < 64; ++d) s += qv[d] * kr[d];
      s += p.rel_bias[t5_bucket(q - kp) * 8 + h];
      float e = expf(s - m);
      l += e;
#pragma unroll
      for (int d = 0; d < 64; ++d) o[d] += e * vr[d];
    }
  }
  float gate = sigmoidf_(p.proj[n * DIP + C_G + h * 3 + 1]);
  float inv = gate / fmaxf(l, 1e-30f);
  float* ar = p.attn + n * 512 + h * 64;
#pragma unroll
  for (int d = 0; d < 64; ++d) ar[d] += o[d] * inv;
}
HD inline void s_win_attn(const P& p, long i) {
  int h = (int)(i % 8); long n = i / 8; int q = (int)(n % T_); int b = (int)(n / T_);
  int g = h / 4;
  const float* qr = p.proj + n * DIP + C_Q + h * 64;
  float qv[64];
#pragma unroll
  for (int d = 0; d < 64; ++d) qv[d] = qr[d] * 0.125f;
  int k0 = q - 511; if (k0 < 0) k0 = 0;
  float m = NEGF;
  for (int kp = k0; kp <= q; ++kp) {
    const float* kr = p.proj + ((long)b * T_ + kp) * DIP + C_KW + g * 64;
    float s = 0.f;
#pragma unroll
    for (int d = 0; d < 64; ++d) s += qv[d] * kr[d];
    s += p.rel_bias[t5_bucket(q - kp) * 8 + h];
    m = s > m ? s : m;
  }
  float o[64];
#pragma unroll
  for (int d = 0; d < 64; ++d) o[d] = 0.f;
  float l = 0.f;
  for (int kp = k0; kp <= q; ++kp) {
    const float* kr = p.proj + ((long)b * T_ + kp) * DIP + C_KW + g * 64;
    const float* vr = p.proj + ((long)b * T_ + kp) * DIP + C_VW + g * 64;
    float s = 0.f;
#pragma unroll
    for (int d = 0; d < 64; ++d) s += qv[d] * kr[d];
    s += p.rel_bias[t5_bucket(q - kp) * 8 + h];
    float e = expf(s - m);
    l += e;
#pragma unroll
    for (int d = 0; d < 64; ++d) o[d] += e * vr[d];
  }
  float gate = sigmoidf_(p.proj[n * DIP + C_G + h * 3 + 2]);
  float inv = gate / fmaxf(l, 1e-30f);
  float* ar = p.attn + n * 512 + h * 64;
#pragma unroll
  for (int d = 0; d < 64; ++d) ar[d] += o[d] * inv;
}
HD inline float s_xc(const P& p, int b, int t, int ch) {
  float acc = p.conv_b[ch];
  for (int w = 0; w < 4; ++w) {
    int tt = t - 3 + w;
    if (tt >= 0) acc += p.conv_w[w * 512 + ch] * p.proj[((long)b * T_ + tt) * DIP + C_RX + ch];
  }
  return acc;
}
HD inline void s_rg_gates(const P& p, long i) {
  int c = (int)(i % 512); long n = i / 512; int t = (int)(n % T_); int b = (int)(n / T_);
  int nb = c / 64, j = c % 64;
  float ra = 0.f, rx = 0.f;
  for (int k = 0; k < 64; ++k) {
    float xv = s_xc(p, b, t, nb * 64 + k);
    ra += xv * p.w_a[(nb * 64 + k) * 64 + j];
    rx += xv * p.w_x[(nb * 64 + k) * 64 + j];
  }
  float r = sigmoidf_(ra + p.b_a[c]);
  float ig = sigmoidf_(rx + p.b_x[c]);
  float lam = p.lam[c];
  float sp = (-lam > 20.f) ? -lam : log1pf(expf(-lam));
  float log_a = -8.f * r * sp;
  float a = expf(log_a);
  float bt = sqrtf(-expm1f(2.f * log_a)) * (ig * s_xc(p, b, t, c));
  p.ra[i] = a; p.rb[i] = bt;
}
HD inline void s_scan(const P& p, long i) {
  int c = (int)(i % 512); int b = (int)(i / 512);
  float h = 0.f;
  for (int t = 0; t < T_; ++t) {
    long n = (long)b * T_ + t;
    h = p.ra[n * 512 + c] * h + p.rb[n * 512 + c];
    float y = p.proj[n * DIP + C_RY + c];
    float ge = 0.5f * y * (1.f + tanhf(0.7978845608028654f * (y + 0.044715f * y * y * y)));
    p.rb[n * 512 + c] = h * ge;
  }
}
HD inline void s_rms(const P& p, long i) {
  int half = (int)(i % 2); long n = i / 2;
  const float* r = (half ? p.rb : p.attn) + n * 512;
  float ss = 0.f;
  for (int k = 0; k < 512; ++k) ss += r[k] * r[k];
  p.invrms[i] = 1.f / sqrtf(ss / 512.f + 1e-6f);
}
HD inline void s_mix(const P& p, long i) {
  int d = (int)(i % DM); long n = i / DM;
  float i0 = p.invrms[n * 2], i1 = p.invrms[n * 2 + 1];
  const float* ar = p.attn + n * 512; const float* rr = p.rb + n * 512;
  float acc = 0.f;
  for (int k = 0; k < 512; ++k) acc += (ar[k] * i0 * p.g_attn[k]) * p.w_out[(long)k * DM + d];
  for (int k = 0; k < 512; ++k) acc += (rr[k] * i1 * p.g_rnn[k]) * p.w_out[(long)(512 + k) * DM + d];
  p.x1[i] = ALPHA * p.x[i] + acc;
}
HD inline void ln_row(float* r, const float* g, const float* b) {
  float mu = 0.f;
  for (int k = 0; k < DM; ++k) mu += r[k];
  mu /= DM;
  float var = 0.f;
  for (int k = 0; k < DM; ++k) { float d = r[k] - mu; var += d * d; }
  var /= DM;
  float inv = 1.f / sqrtf(var + 1e-5f);
  for (int k = 0; k < DM; ++k) r[k] = (r[k] - mu) * inv * g[k] + b[k];
}
HD inline void s_ln1(const P& p, long i) { ln_row(p.x1 + i * DM, p.ln1_g, p.ln1_b); }
HD inline void s_ln2(const P& p, long i) { ln_row(p.out + i * DM, p.ln2_g, p.ln2_b); }
HD inline void s_router(const P& p, long n) {
  const float* t = p.x1 + n * DM;
  float lg0 = p.bg[0], lg1 = p.bg[1], lg2 = p.bg[2], lg3 = p.bg[3];
  for (int k = 0; k < DM; ++k) {
    float v = t[k];
    lg0 += v * p.wg[k * 4 + 0]; lg1 += v * p.wg[k * 4 + 1]; lg2 += v * p.wg[k * 4 + 2]; lg3 += v * p.wg[k * 4 + 3];
  }
  int gi = 0; float gm = lg0;
  if (lg1 > gm) { gm = lg1; gi = 1; }
  if (lg2 > gm) { gm = lg2; gi = 2; }
  if (lg3 > gm) { gm = lg3; gi = 3; }
  float pg_top = 1.f / (expf(lg0 - gm) + expf(lg1 - gm) + expf(lg2 - gm) + expf(lg3 - gm));
  float e0 = p.be[gi * 4 + 0], e1 = p.be[gi * 4 + 1], e2 = p.be[gi * 4 + 2], e3 = p.be[gi * 4 + 3];
  for (int k = 0; k < DM; ++k) {
    float v = t[k];
    const float* w = p.we + k * 16 + gi * 4;
    e0 += v * w[0]; e1 += v * w[1]; e2 += v * w[2]; e3 += v * w[3];
  }
  int i1 = 0; float v1 = e0;
  if (e1 > v1) { v1 = e1; i1 = 1; }
  if (e2 > v1) { v1 = e2; i1 = 2; }
  if (e3 > v1) { v1 = e3; i1 = 3; }
  int i2 = -1; float v2 = -3e38f;
  if (i1 != 0 && e0 > v2) { v2 = e0; i2 = 0; }
  if (i1 != 1 && e1 > v2) { v2 = e1; i2 = 1; }
  if (i1 != 2 && e2 > v2) { v2 = e2; i2 = 2; }
  if (i1 != 3 && e3 > v2) { v2 = e3; i2 = 3; }
  float a1 = 1.f, a2 = expf(v2 - v1);
  float s = a1 + a2;
  p.eid[n * 2 + 0] = gi * 4 + i1; p.eid[n * 2 + 1] = gi * 4 + i2;
  p.ew[n * 2 + 0] = pg_top * a1 / s; p.ew[n * 2 + 1] = pg_top * a2 / s;
}
HD inline void s_moe_up(const P& p, long i) {
  int j = (int)(i % 512); long r = i / 512; int slot = (int)(r % 2); long n = r / 2;
  int e = p.eid[n * 2 + slot];
  const float* t = p.x1 + n * DM;
  const float* w = p.w_up + (long)e * DM * 1024;
  float ua = 0.f, ub = 0.f;
  for (int k = 0; k < DM; ++k) { float v = t[k]; ua += v * w[(long)k * 1024 + j]; ub += v * w[(long)k * 1024 + 512 + j]; }
  p.hid[i] = (ua / (1.f + expf(-ua))) * ub;
}
HD inline void s_final(const P& p, long i) {
  int d = (int)(i % DM); long n = i / DM;
  const float* t = p.x1 + n * DM;
  float moe = 0.f;
  for (int slot = 0; slot < 2; ++slot) {
    int e = p.eid[n * 2 + slot];
    const float* hrow = p.hid + (n * 2 + slot) * 512;
    const float* w = p.w_down + (long)e * 512 * DM;
    float acc = 0.f;
    for (int j = 0; j < 512; ++j) acc += hrow[j] * w[(long)j * DM + d];
    moe += p.ew[n * 2 + slot] * acc;
  }
  float gl = 0.f;
  for (int k = 0; k < DM; ++k) gl += t[k] * p.ple_gate[(long)k * DM + d];
  float pl = 0.f;
  const float* pr = p.p + n * 256;
  for (int k = 0; k < 256; ++k) pl += pr[k] * p.ple_w[(long)k * DM + d];
  p.out[i] = ALPHA * t[d] + moe + sigmoidf_(gl) * pl;
}

inline void setup_params(P& p, void* const* d_in, void* d_out, void* d_ws) {
  const float** f = (const float**)&p;
  for (int i = 0; i < 30; ++i) f[i] = (const float*)d_in[i];
  p.out = (float*)d_out;
  float* w = (float*)d_ws;
  size_t o = 0;
  auto take = [&](size_t n) { float* r = w + o; o += (n + 63) & ~(size_t)63; return r; };
  p.proj = take((size_t)NTOK * DIP);
  p.attn = take((size_t)NTOK * 512);
  p.rb = take((size_t)NTOK * 512);
  p.kc = take((size_t)B_ * NCMP * 128);
  p.vc = take((size_t)B_ * NCMP * 128);
  p.invrms = take((size_t)NTOK * 2);
  p.ew = take((size_t)NTOK * 2);
  p.eid = (int*)take((size_t)NTOK * 2);
  float* o2 = (float*)d_out;
  p.ra = o2;
  p.imp = o2;
  p.sel = (int*)(o2 + (size_t)NTOK * 256);
  p.mc = o2 + (size_t)NTOK * 320;
  p.lc = o2 + (size_t)NTOK * 336;
  p.x1 = p.proj;
  p.hid = p.proj + (size_t)NTOK * DM;
}
}

#ifndef CPU_EMU
#define STAGE_KERNEL(name)                                                                      \
  __global__ void __launch_bounds__(256) k_##name(P p, long n) {                                \
    for (long i = (long)blockIdx.x * blockDim.x + threadIdx.x; i < n; i += (long)gridDim.x * blockDim.x) name(p, i); \
  }
STAGE_KERNEL(s_proj) STAGE_KERNEL(s_compress) STAGE_KERNEL(s_cmp_attn) STAGE_KERNEL(s_imp) STAGE_KERNEL(s_topk)
STAGE_KERNEL(s_sel_attn) STAGE_KERNEL(s_win_attn) STAGE_KERNEL(s_rg_gates) STAGE_KERNEL(s_scan) STAGE_KERNEL(s_rms)
STAGE_KERNEL(s_mix) STAGE_KERNEL(s_ln1) STAGE_KERNEL(s_router) STAGE_KERNEL(s_moe_up) STAGE_KERNEL(s_final) STAGE_KERNEL(s_ln2)

#define RUN(name, n)                                                                   \
  do {                                                                                 \
    long nn = (long)(n);                                                               \
    long nb = (nn + 255) / 256;                                                        \
    if (nb > 65536 * 4) nb = 65536 * 4;                                                \
    hipLaunchKernelGGL(k_##name, dim3((unsigned)nb), dim3(256), 0, stream, p, nn);     \
  } while (0)

extern "C" void kernel_launch(void* const* d_in, const int* in_sizes, int n_in, void* d_out, int out_size, void* d_ws,
                              size_t ws_size, hipStream_t stream) {
  P p{};
  setup_params(p, d_in, d_out, d_ws);
  RUN(s_proj, (long)NTOK * DIP);
  RUN(s_rg_gates, (long)NTOK * 512);
  RUN(s_scan, (long)B_ * 512);
  RUN(s_compress, 2L * B_ * NCMP * 128);
  RUN(s_cmp_attn, (long)NTOK * 8);
  RUN(s_imp, (long)B_ * 2 * T_ * NSLC);
  RUN(s_topk, (long)B_ * 2 * T_);
  RUN(s_sel_attn, (long)NTOK * 8);
  RUN(s_win_attn, (long)NTOK * 8);
  RUN(s_rms, (long)NTOK * 2);
  RUN(s_mix, (long)NTOK * DM);
  RUN(s_ln1, (long)NTOK);
  RUN(s_router, (long)NTOK);
  RUN(s_moe_up, (long)NTOK * 1024);
  RUN(s_final, (long)NTOK * DM);
  RUN(s_ln2, (long)NTOK);
}
#endif
```
